# Optimizing an MI355X kernel written in HIP

```python
import math
import jax, jax.numpy as jnp
from jax import lax
import numpy as np


D_MODEL = 1024
BATCH = 8
SEQ = 4096
DEPTH = 1

CTX_LEN = 256
GRID_W = 64
RET_WIDTH = 512
LRU_WIDTH = 512
MIX_WIDTH = RET_WIDTH + LRU_WIDTH
RET_HEADS = 4
RET_HEAD_DIM = RET_WIDTH // RET_HEADS
RET_CHUNK = 128
LRU_BLOCKS = 8
LRU_BLOCK_DIM = LRU_WIDTH // LRU_BLOCKS
LRU_C = 8.0
CONV_WIDTH = 4
MLP_HIDDEN = 4 * D_MODEL
ROPE_BASE = 10000.0
NORM_EPS = 1e-6
N_MOD = 6
IN_COLS = 4 * RET_WIDTH + 2 * LRU_WIDTH
IN_SPLITS = (RET_WIDTH, 2 * RET_WIDTH, 3 * RET_WIDTH, 4 * RET_WIDTH, 4 * RET_WIDTH + LRU_WIDTH)

kernel_name = "hybrid_retention_rglru_dit_block"


def rmsnorm(x, g):
    xf = x.astype(jnp.float32)
    y = xf * lax.rsqrt(jnp.mean(xf * xf, axis=-1, keepdims=True) + NORM_EPS)
    return (y * g.astype(jnp.float32)).astype(x.dtype)


def modulate(h, shift, scale):
    return h * (1.0 + scale) + shift


def to_heads(a):
    b, t, _ = a.shape
    return a.reshape(b, t, RET_HEADS, RET_HEAD_DIM).astype(jnp.float32)


def head_groupnorm(y):
    mu = jnp.mean(y, axis=-1, keepdims=True)
    yc = y - mu
    var = jnp.mean(yc * yc, axis=-1, keepdims=True)
    return yc * lax.rsqrt(var + NORM_EPS)


def axial_rotary_tables(t_len):
    rows = t_len // GRID_W
    row = jnp.repeat(jnp.arange(rows, dtype=jnp.float32), GRID_W)
    col = jnp.tile(jnp.arange(GRID_W, dtype=jnp.float32), rows)
    n_freq = RET_HEAD_DIM // 4
    inv = ROPE_BASE ** (-jnp.arange(n_freq, dtype=jnp.float32) / n_freq)
    ang = jnp.concatenate([row[:, None] * inv, col[:, None] * inv], axis=-1)
    return jnp.cos(ang), jnp.sin(ang)


def apply_rotary(x, cos, sin):
    half = RET_HEAD_DIM // 2
    x1, x2 = x[..., :half], x[..., half:]
    c = cos[None, :, None, :]
    s = sin[None, :, None, :]
    return jnp.concatenate([x1 * c - x2 * s, x2 * c + x1 * s], axis=-1)


def retention_scan(q, k, v, log_g, s0):
    b, t, h, dh = q.shape
    n = t // RET_CHUNK

    def chunks(a):
        return a.reshape(b, n, RET_CHUNK, h, dh).transpose(0, 3, 1, 2, 4)

    qc, kc, vc = chunks(q), chunks(k), chunks(v)
    pos = jnp.arange(RET_CHUNK, dtype=jnp.float32)
    lg = log_g[:, None]
    rel = pos[:, None] - pos[None, :]
    decay = jnp.where(rel >= 0, jnp.exp(lg[:, :, None] * jnp.maximum(rel, 0.0)), 0.0)
    scores = jnp.einsum('bhncd,bhnmd->bhncm', qc, kc) * decay[None, :, None]
    intra = jnp.einsum('bhncm,bhnme->bhnce', scores, vc)
    w_state = jnp.exp(lg * (RET_CHUNK - 1.0 - pos))
    u = jnp.einsum('bhncd,bhnce->bhnde', kc * w_state[None, :, None, :, None], vc)
    g_chunk = jnp.exp(lg * RET_CHUNK)[None, :, :, None]

    def step(s, u_n):
        return g_chunk * s + u_n, s

    _, s_prev = lax.scan(step, s0, u.transpose(2, 0, 1, 3, 4))
    s_prev = s_prev.transpose(1, 2, 0, 3, 4)
    w_query = jnp.exp(lg * (pos + 1.0))
    cross = jnp.einsum('bhncd,bhnde->bhnce', qc * w_query[None, :, None, :, None], s_prev)
    return (intra + cross).transpose(0, 2, 3, 1, 4).reshape(b, t, h, dh)


def retention_bidir(q, k, v, log_g_f, log_g_b, s0_f, s0_b):
    o_f = retention_scan(q, k, v, log_g_f, s0_f)
    o_b = retention_scan(q[:, ::-1], k[:, ::-1], v[:, ::-1], log_g_b, s0_b)[:, ::-1]
    return o_f + o_b


def retention_final_state(k, v, log_g, reverse):
    l_len = k.shape[1]
    pos = jnp.arange(l_len, dtype=jnp.float32)
    steps = pos if reverse else (l_len - 1.0 - pos)
    w = jnp.exp(log_g[:, None] * steps[None, :])
    return jnp.einsum('blhd,blhe->bhde', k * w.T[None, :, :, None], v)


def centred_depthwise_conv(x, w, bias):
    t_len = x.shape[1]
    left = (CONV_WIDTH - 1) // 2
    right = CONV_WIDTH - 1 - left
    xp = jnp.pad(x, ((0, 0), (left, right), (0, 0)))
    out = bias + xp[:, 0:t_len] * w[0]
    for j in range(1, CONV_WIDTH):
        out = out + xp[:, j:j + t_len] * w[j]
    return out


def linear_scan(a, b, h0, reverse):
    if reverse:
        a, b = a[:, ::-1], b[:, ::-1]
    b = b.at[:, 0].add(a[:, 0] * h0)

    def combine(lhs, rhs):
        return lhs[0] * rhs[0], rhs[0] * lhs[1] + rhs[1]

    _, h = lax.associative_scan(combine, (a, b), axis=1)
    final = h[:, -1]
    if reverse:
        h = h[:, ::-1]
    return h, final


def rglru_direction(xc, w_a, b_a, w_x, b_x, lam, h0, reverse):
    b, t, _ = xc.shape
    xf = xc.astype(jnp.float32)
    xb = xf.reshape(b, t, LRU_BLOCKS, LRU_BLOCK_DIM)
    r = jax.nn.sigmoid(jnp.einsum('btnd,nde->btne', xb, w_a.astype(jnp.float32)).reshape(b, t, LRU_WIDTH) + b_a.astype(jnp.float32))
    i = jax.nn.sigmoid(jnp.einsum('btnd,nde->btne', xb, w_x.astype(jnp.float32)).reshape(b, t, LRU_WIDTH) + b_x.astype(jnp.float32))
    log_a = -LRU_C * r * jax.nn.softplus(-lam.astype(jnp.float32))
    a = jnp.exp(log_a)
    inp = jnp.sqrt(-jnp.expm1(2.0 * log_a)) * (i * xf)
    return linear_scan(a, inp, h0, reverse)


def mix_output(o_ret, g, h_lru, gate, w_out):
    b, t = g.shape[0], g.shape[1]
    ret = jax.nn.silu(g.astype(jnp.float32)) * head_groupnorm(o_ret).reshape(b, t, RET_WIDTH)
    lru = h_lru * jax.nn.gelu(gate.astype(jnp.float32))
    return jnp.concatenate([ret, lru], axis=-1).astype(w_out.dtype) @ w_out


def squared_relu_mlp(h, w1, w2):
    return jnp.square(jax.nn.relu(h @ w1)) @ w2


def setup_inputs(seed: int = 0) -> dict:
    key = jax.random.key(seed)
    ks = jax.random.split(key, 24)
    f32 = jnp.float32

    def nrm(k, shape, scale):
        return jax.random.normal(k, shape, f32) * scale

    x = nrm(ks[0], (BATCH, SEQ, D_MODEL), 1.0)
    c = nrm(ks[1], (BATCH, D_MODEL), 1.0)
    ctx = nrm(ks[2], (BATCH, CTX_LEN, D_MODEL), 1.0)
    c_ctx = nrm(ks[3], (D_MODEL,), 1.0)
    w_ada = nrm(ks[4], (DEPTH, D_MODEL, N_MOD * D_MODEL), 0.5 * D_MODEL ** -0.5)
    b_ada = nrm(ks[5], (DEPTH, N_MOD * D_MODEL), 0.01)
    norm1_g = 1.0 + nrm(ks[6], (DEPTH, D_MODEL), 0.02)
    norm2_g = 1.0 + nrm(ks[7], (DEPTH, D_MODEL), 0.02)
    w_in = nrm(ks[8], (DEPTH, D_MODEL, IN_COLS), D_MODEL ** -0.5)
    gamma = 1.0 - 2.0 ** (-5.0 - jnp.arange(RET_HEADS, dtype=f32))
    ret_decay = jnp.log(gamma) - jnp.log1p(-gamma) + nrm(ks[9], (DEPTH, 2, RET_HEADS), 0.05)
    conv_w = nrm(ks[10], (DEPTH, CONV_WIDTH, LRU_WIDTH), CONV_WIDTH ** -0.5)
    conv_b = nrm(ks[11], (DEPTH, LRU_WIDTH), 0.01)
    lru_wa = nrm(ks[12], (DEPTH, 2, LRU_BLOCKS, LRU_BLOCK_DIM, LRU_BLOCK_DIM), LRU_BLOCK_DIM ** -0.5)
    lru_ba = nrm(ks[13], (DEPTH, 2, LRU_WIDTH), 0.01)
    lru_wx = nrm(ks[14], (DEPTH, 2, LRU_BLOCKS, LRU_BLOCK_DIM, LRU_BLOCK_DIM), LRU_BLOCK_DIM ** -0.5)
    lru_bx = nrm(ks[15], (DEPTH, 2, LRU_WIDTH), 0.01)
    u = jax.random.uniform(ks[16], (DEPTH, 2, LRU_WIDTH), f32, 0.9, 0.999)
    a0 = u ** (1.0 / LRU_C)
    lru_lambda = jnp.log(a0) - jnp.log1p(-a0)
    w_out = nrm(ks[17], (DEPTH, MIX_WIDTH, D_MODEL), MIX_WIDTH ** -0.5)
    w_mlp1 = nrm(ks[18], (DEPTH, D_MODEL, MLP_HIDDEN), D_MODEL ** -0.5)
    w_mlp2 = nrm(ks[19], (DEPTH, MLP_HIDDEN, D_MODEL), MLP_HIDDEN ** -0.5)
    final_g = 1.0 + nrm(ks[20], (D_MODEL,), 0.02)
    return dict(x=x, c=c, ctx=ctx, c_ctx=c_ctx, w_ada=w_ada, b_ada=b_ada, norm1_g=norm1_g,
                norm2_g=norm2_g, w_in=w_in, ret_decay=ret_decay, conv_w=conv_w, conv_b=conv_b,
                lru_wa=lru_wa, lru_ba=lru_ba, lru_wx=lru_wx, lru_bx=lru_bx, lru_lambda=lru_lambda,
                w_out=w_out, w_mlp1=w_mlp1, w_mlp2=w_mlp2, final_g=final_g)


def reference(x, c, ctx, c_ctx, w_ada, b_ada, norm1_g, norm2_g, w_in, ret_decay, conv_w, conv_b,
              lru_wa, lru_ba, lru_wx, lru_bx, lru_lambda, w_out, w_mlp1, w_mlp2, final_g):
    b, t_len, _ = x.shape
    cos, sin = axial_rotary_tables(t_len)
    k_scale = RET_HEAD_DIM ** -0.5
    silu_c = jax.nn.silu(c)
    silu_cc = jax.nn.silu(c_ctx)
    for l in range(DEPTH):
        last = l == DEPTH - 1
        mod = silu_c @ w_ada[l] + b_ada[l]
        mod_c = silu_cc @ w_ada[l] + b_ada[l]
        sh1, sc1, g1, sh2, sc2, g2 = [m[:, None] for m in jnp.split(mod, N_MOD, axis=-1)]
        csh1, csc1, cg1, csh2, csc2, cg2 = jnp.split(mod_c, N_MOD, axis=-1)
        w_q, w_k, w_v, w_g, w_x, w_gate = jnp.split(w_in[l], IN_SPLITS, axis=1)
        lg_f = jax.nn.log_sigmoid(ret_decay[l, 0].astype(jnp.float32))
        lg_b = jax.nn.log_sigmoid(ret_decay[l, 1].astype(jnp.float32))
        lru_f = (lru_wa[l, 0], lru_ba[l, 0], lru_wx[l, 0], lru_bx[l, 0], lru_lambda[l, 0])
        lru_b = (lru_wa[l, 1], lru_ba[l, 1], lru_wx[l, 1], lru_bx[l, 1], lru_lambda[l, 1])

        hc = modulate(rmsnorm(ctx, norm1_g[l]), csh1, csc1)
        kc = to_heads(hc @ w_k) * k_scale
        vc = to_heads(hc @ w_v)
        s_f = retention_final_state(kc, vc, lg_f, False)
        s_b = retention_final_state(kc, vc, lg_b, True)
        xcc = centred_depthwise_conv(hc @ w_x, conv_w[l], conv_b[l])
        zero_h = jnp.zeros((b, LRU_WIDTH), jnp.float32)
        hcf, lru_sf = rglru_direction(xcc, *lru_f, zero_h, False)
        hcb, lru_sb = rglru_direction(xcc, *lru_b, zero_h, True)
        if not last:
            qc = to_heads(hc @ w_q)
            zero_s = jnp.zeros((b, RET_HEADS, RET_HEAD_DIM, RET_HEAD_DIM), jnp.float32)
            o_c = retention_bidir(qc, kc, vc, lg_f, lg_b, zero_s, zero_s)
            yc = mix_output(o_c, hc @ w_g, hcf + hcb, hc @ w_gate, w_out[l])
            ctx_next = ctx + cg1 * yc
            hc2 = modulate(rmsnorm(ctx_next, norm2_g[l]), csh2, csc2)
            ctx_next = ctx_next + cg2 * squared_relu_mlp(hc2, w_mlp1[l], w_mlp2[l])

        h = modulate(rmsnorm(x, norm1_g[l]), sh1, sc1)
        q, k, v, g, xr, gate = jnp.split(h @ w_in[l], IN_SPLITS, axis=-1)
        q = apply_rotary(to_heads(q), cos, sin)
        k = apply_rotary(to_heads(k), cos, sin) * k_scale
        o = retention_bidir(q, k, to_heads(v), lg_f, lg_b, s_f, s_b)
        xcl = centred_depthwise_conv(xr, conv_w[l], conv_b[l])
        hf, _ = rglru_direction(xcl, *lru_f, lru_sf, False)
        hb, _ = rglru_direction(xcl, *lru_b, lru_sb, True)
        y = mix_output(o, g, hf + hb, gate, w_out[l])
        x = x + g1 * y
        h2 = modulate(rmsnorm(x, norm2_g[l]), sh2, sc2)
        x = x + g2 * squared_relu_mlp(h2, w_mlp1[l], w_mlp2[l])
        if not last:
            ctx = ctx_next
    return rmsnorm(x, final_g)
```

```cpp
#define MK_N_LAUNCHES 9
#include <hip/hip_runtime.h>
#include <hip/hip_cooperative_groups.h>
#include <cstdio>
#include <cstdint>
namespace cg = cooperative_groups;
#ifndef MK_N_LAUNCHES
#define MK_N_LAUNCHES 1
#endif
namespace pg8 {
#define PG8_LAS __attribute__((address_space(3)))
typedef unsigned short bf16_t;
typedef short bf16x8 __attribute__((ext_vector_type(8)));
typedef float f32x4 __attribute__((ext_vector_type(4)));
typedef unsigned u32x4 __attribute__((ext_vector_type(4)));
constexpr int BM = 256, BK = 64, HALF = 128, HTB = HALF * BK * 2  , STAGE_BYTES = 8 * HTB, NXCD = 8, WGM = 8;

__host__ __device__ __forceinline__ int lds_byte(int r, int c) { const int st = (r >> 4) * 2 + (c >> 5), rr = r & 15, cc = c & 31, ob = rr * 64 + cc * 2; return st * 1024 + (ob ^ (((ob >> 9) & 1) << 5)); }
__host__ __device__ __forceinline__ void stage_rc(int b, int& R, int& C) { const int st = b / 1024, sb = b % 1024, swz = sb ^ (((sb >> 9) & 1) << 5); R = (st >> 1) * 16 + swz / 64; C = (st & 1) * 32 + (swz % 64) / 2; }
__host__ __device__ __forceinline__ int perm32(int rho) { const int n = rho >> 4, i = rho & 15; return 8 * (i >> 2) + 4 * n + (i & 3); }

struct Unit { int pm, pn; };
struct Gemm { const bf16_t* A; const bf16_t* Bt; int M, N, K; };

struct StaticOrder {
    int nM, nN, nwg, G, c;
    __host__ __device__ void init(int M, int N, int G_, int c_) { nM = M / BM; nN = N / BM; nwg = nM * nN; G = G_; c = c_; }
    __host__ __device__ bool next(int i, Unit& u) const {
        const long L = (long)i * G + c; if (L >= nwg) return false;
        int wgid = (int)L; { const int q = nwg / NXCD, r = nwg % NXCD, xcd = wgid % NXCD, off = wgid / NXCD; wgid = (xcd < r ? xcd * (q + 1) : r * (q + 1) + (xcd - r) * q) + off; }
        const int nig = WGM * nN, gid = wgid / nig, fm = gid * WGM, gsz = (nM - fm) < WGM ? (nM - fm) : WGM;
        u.pm = fm + ((wgid % nig) % gsz); u.pn = (wgid % nig) / gsz; return true;
    }
    __device__ __forceinline__ void a_ready(const Unit&) const {}
    __device__ __forceinline__ void done(const Unit&) const {}
};

__device__ __forceinline__ unsigned cvt_pk_bf16(float lo, float hi) { unsigned r; asm volatile("v_cvt_pk_bf16_f32 %0, %1, %2" : "=v"(r) : "v"(lo), "v"(hi)); return r; }
typedef float f32x2 __attribute__((ext_vector_type(2)));
template <class Epi, class Sched, bool ALIGN_EPI = false, bool SP2 = false>
__device__ __forceinline__ void gemm_phase(PG8_LAS unsigned char* lds, const Gemm g, const Sched& S, const Epi& E) {
    const int tid = threadIdx.x, wid = __builtin_amdgcn_readfirstlane(tid >> 6), lane = tid & 63, wr = wid >> 2, wc = wid & 3, fr = lane & 15, fq = lane >> 4;
    const int K = g.K, nt = K / BK;
    unsigned voffA[2], voffB[2];
#pragma unroll
    for (int i = 0; i < 2; ++i) { int R, C; stage_rc(tid * 16 + i * 8192, R, C); const int Rb = Epi::PERM ? ((R & ~31) + perm32(R & 31)) : R;
        voffA[i] = (unsigned)(R * K + C) * 2u; voffB[i] = (unsigned)(Rb * K + C) * 2u; }
    const size_t kstep = (size_t)(BK * 2);
    const size_t hstep = (size_t)HALF * K * 2;
    const size_t tstep = 2 * hstep;
    const unsigned ldsw = (unsigned)wid * 1024u;
    const int aoff = lds_byte(wr * 64 + fr, fq * 8), boff = lds_byte(wc * 32 + fr, fq * 8);
#define PG8_SA(b, h) (((b) * 2 + (h)) * HTB)
#define PG8_SB(b, h) ((4 + (b) * 2 + (h)) * HTB)
#define PG8_STAGE(bufoff, gbase, voff) do { _Pragma("unroll") for (int _i = 0; _i < 2; ++_i) \
        __builtin_amdgcn_global_load_lds((const unsigned*)((const char*)(gbase) + (voff)[_i]), (PG8_LAS unsigned*)(lds + (bufoff) + ldsw + _i * 8192), 16, 0, 0); } while (0)
#define PG8_LDA(dst, b, h) do { _Pragma("unroll") for (int m = 0; m < 4; ++m) _Pragma("unroll") for (int k = 0; k < 2; ++k) dst[m][k] = *(const PG8_LAS bf16x8*)(lds + PG8_SA(b, h) + aoff + m * 2048 + k * 1024); } while (0)
#define PG8_LDB(dst, b, h) do { _Pragma("unroll") for (int n = 0; n < 2; ++n) _Pragma("unroll") for (int k = 0; k < 2; ++k) dst[n][k] = *(const PG8_LAS bf16x8*)(lds + PG8_SB(b, h) + boff + n * 2048 + k * 1024); } while (0)
#define PG8_MMA(ai, bj, At, Bt) do { __builtin_amdgcn_s_setprio(1); _Pragma("unroll") for (int m = 0; m < 4; ++m) _Pragma("unroll") for (int n = 0; n < 2; ++n) _Pragma("unroll") for (int k = 0; k < 2; ++k) \
        acc[ai][bj][m][n] = __builtin_amdgcn_mfma_f32_16x16x32_bf16(Bt[n][k], At[m][k], acc[ai][bj][m][n], 0, 0, 0); __builtin_amdgcn_s_setprio(0); } while (0)
#define PG8_WAIT_V(n) asm volatile("s_waitcnt vmcnt(" #n ")" ::: "memory")
#define PG8_WAIT_L(n) asm volatile("s_waitcnt lgkmcnt(" #n ")" ::: "memory")
#define PG8_BAR __builtin_amdgcn_s_barrier()
#define PG8_SCHED __builtin_amdgcn_sched_barrier(0)
    Unit cur, nxt; int ui = 0;
    if (!S.next(0, cur)) return;
    f32x4 acc[2][2][4][2];
#pragma unroll
    for (int a = 0; a < 2; ++a)
#pragma unroll
        for (int b = 0; b < 2; ++b)
#pragma unroll
            for (int m = 0; m < 4; ++m)
#pragma unroll
                for (int n = 0; n < 2; ++n) acc[a][b][m][n] = (f32x4){0.f, 0.f, 0.f, 0.f};
    bf16x8 At[4][2], B0[2][2], B1[2][2];
    const char* cA = (const char*)g.A + (size_t)cur.pm * tstep; const char* cB = (const char*)g.Bt + (size_t)cur.pn * tstep;
    S.a_ready(cur);
    if constexpr (SP2) {
        PG8_STAGE(PG8_SB(0, 0), cB, voffB); PG8_STAGE(PG8_SB(0, 1), cB + hstep, voffB); PG8_STAGE(PG8_SA(0, 0), cA, voffA); PG8_STAGE(PG8_SA(0, 1), cA + hstep, voffA);
        if (wr == 1) PG8_BAR;
        PG8_WAIT_V(2); PG8_BAR;
        PG8_STAGE(PG8_SB(1, 0), cB + kstep, voffB); PG8_STAGE(PG8_SA(1, 0), cA + kstep, voffA); PG8_STAGE(PG8_SB(1, 1), cB + hstep + kstep, voffB);
        PG8_WAIT_V(6); PG8_BAR;
    } else {
        PG8_STAGE(PG8_SB(0, 0), cB, voffB); PG8_STAGE(PG8_SA(0, 0), cA, voffA); PG8_STAGE(PG8_SB(0, 1), cB + hstep, voffB); PG8_STAGE(PG8_SA(0, 1), cA + hstep, voffA);
        if (wr == 1) PG8_BAR;
        PG8_WAIT_V(4); PG8_BAR;
        PG8_STAGE(PG8_SB(1, 0), cB + kstep, voffB); PG8_STAGE(PG8_SA(1, 0), cA + kstep, voffA); PG8_STAGE(PG8_SB(1, 1), cB + hstep + kstep, voffB);
        PG8_WAIT_V(6); PG8_BAR;
    }
    for (;;) {
        const bool has_next = S.next(ui + 1, nxt);
        const char* nA = has_next ? (const char*)g.A + (size_t)nxt.pm * tstep : cA; const char* nB = has_next ? (const char*)g.Bt + (size_t)nxt.pn * tstep : cB;
        for (int t = 0; t < nt; t += 2) {
            const bool last = (t == nt - 2);
            const char* a1 = cA + (size_t)(t + 1) * kstep;
            const char* a2 = last ? nA : cA + (size_t)(t + 2) * kstep; const char* b2 = last ? nB : cB + (size_t)(t + 2) * kstep;
            const char* a3 = a2 + kstep; const char* b3 = b2 + kstep;
            if (last && has_next) S.a_ready(nxt);
            if constexpr (SP2) {
            PG8_LDB(B0, 0, 0); PG8_LDB(B1, 0, 1); PG8_SCHED; PG8_LDA(At, 0, 0); PG8_STAGE(PG8_SA(1, 1), a1 + hstep, voffA);
            PG8_WAIT_V(8); PG8_WAIT_L(0); PG8_BAR; PG8_MMA(0, 0, At, B0); PG8_MMA(0, 1, At, B1); PG8_BAR; PG8_SCHED;
            PG8_LDA(At, 0, 1); PG8_STAGE(PG8_SB(0, 0), b2, voffB); PG8_STAGE(PG8_SB(0, 1), b2 + hstep, voffB); PG8_STAGE(PG8_SA(0, 0), a2, voffA);
            PG8_WAIT_V(8); PG8_WAIT_L(0); PG8_BAR; PG8_MMA(1, 0, At, B0); PG8_MMA(1, 1, At, B1); PG8_BAR; PG8_SCHED;
            PG8_LDB(B0, 1, 0); PG8_LDB(B1, 1, 1); PG8_SCHED; PG8_LDA(At, 1, 0); PG8_STAGE(PG8_SA(0, 1), a2 + hstep, voffA);
            PG8_WAIT_V(8); PG8_WAIT_L(0); PG8_BAR; PG8_MMA(0, 0, At, B0); PG8_MMA(0, 1, At, B1); PG8_BAR; PG8_SCHED;
            PG8_LDA(At, 1, 1); PG8_STAGE(PG8_SB(1, 0), b3, voffB); PG8_STAGE(PG8_SB(1, 1), b3 + hstep, voffB); PG8_STAGE(PG8_SA(1, 0), a3, voffA);
            PG8_WAIT_V(8); PG8_WAIT_L(0); PG8_BAR; PG8_MMA(1, 0, At, B0); PG8_MMA(1, 1, At, B1); PG8_BAR; PG8_SCHED;
            } else {
            PG8_LDB(B0, 0, 0); PG8_SCHED; PG8_LDA(At, 0, 0); PG8_STAGE(PG8_SA(1, 1), a1 + hstep, voffA);
            PG8_WAIT_L(8); PG8_BAR; PG8_WAIT_L(0); PG8_MMA(0, 0, At, B0); PG8_BAR; PG8_SCHED;
            PG8_LDB(B1, 0, 1); PG8_STAGE(PG8_SB(0, 0), b2, voffB);
            PG8_BAR; PG8_WAIT_L(0); PG8_MMA(0, 1, At, B1); PG8_BAR;
            PG8_LDA(At, 0, 1); PG8_STAGE(PG8_SA(0, 0), a2, voffA);
            PG8_BAR; PG8_WAIT_L(0); PG8_MMA(1, 0, At, B0); PG8_BAR; PG8_SCHED;
            PG8_STAGE(PG8_SB(0, 1), b2 + hstep, voffB);
            PG8_WAIT_V(6); PG8_BAR; PG8_MMA(1, 1, At, B1); PG8_BAR;
            PG8_LDB(B0, 1, 0); PG8_SCHED; PG8_LDA(At, 1, 0); PG8_STAGE(PG8_SA(0, 1), a2 + hstep, voffA);
            PG8_WAIT_L(8); PG8_BAR; PG8_WAIT_L(0); PG8_MMA(0, 0, At, B0); PG8_BAR; PG8_SCHED;
            PG8_LDB(B1, 1, 1); PG8_STAGE(PG8_SB(1, 0), b3, voffB);
            PG8_BAR; PG8_WAIT_L(0); PG8_MMA(0, 1, At, B1); PG8_BAR;
            PG8_LDA(At, 1, 1); PG8_STAGE(PG8_SA(1, 0), a3, voffA);
            PG8_BAR; PG8_WAIT_L(0); PG8_MMA(1, 0, At, B0); PG8_BAR; PG8_SCHED;
            PG8_STAGE(PG8_SB(1, 1), b3 + hstep, voffB);
            PG8_WAIT_V(6); PG8_BAR; PG8_MMA(1, 1, At, B1); PG8_BAR;
            }
        }
        if constexpr (ALIGN_EPI) { if (wr == 0) PG8_BAR; }
        if constexpr (!Epi::AFTER_DRAIN) { E(acc, cur, wr, wc, fr, fq); S.done(cur); }
        if (!has_next) break;
#pragma unroll
        for (int a = 0; a < 2; ++a)
#pragma unroll
            for (int b = 0; b < 2; ++b)
#pragma unroll
                for (int m = 0; m < 4; ++m)
#pragma unroll
                    for (int n = 0; n < 2; ++n) acc[a][b][m][n] = (f32x4){0.f, 0.f, 0.f, 0.f};
        cur = nxt; cA = nA; cB = nB; ++ui;
        if constexpr (ALIGN_EPI) { if (wr == 1) PG8_BAR; }
    }
    PG8_WAIT_V(0);
    if constexpr (!ALIGN_EPI) { if (wr == 0) PG8_BAR; }
    PG8_BAR;
    if constexpr (Epi::AFTER_DRAIN) { E.fused(acc, cur, wr, wc, fr, fq, lds, wid, lane); S.done(cur); }
#undef PG8_SA
#undef PG8_SB
#undef PG8_STAGE
#undef PG8_LDA
#undef PG8_LDB
#undef PG8_MMA
#undef PG8_WAIT_V
#undef PG8_WAIT_L
#undef PG8_BAR
#undef PG8_SCHED
}
}

#define LAS __attribute__((address_space(3)))
typedef unsigned short bf16;
typedef unsigned v4u __attribute__((ext_vector_type(4)));
typedef unsigned v2u __attribute__((ext_vector_type(2)));
typedef float f32x4 __attribute__((ext_vector_type(4)));
typedef short bf16x8 __attribute__((ext_vector_type(8)));
typedef short s16x4 __attribute__((ext_vector_type(4)));
typedef short v4i16_t __attribute__((ext_vector_type(4)));
typedef float f32x2_t __attribute__((ext_vector_type(2)));
typedef __bf16 bf16x2_t __attribute__((ext_vector_type(2)));

constexpr int NB = 8, T = 4096, D = 1024, CTXL = 256, NCOL = 3072, FF = 4096, NMOD = 6144;
constexpr int MX = NB * T, MC = NB * CTXL, MTOT = MX + MC;
constexpr float EPS = 1e-6f;
constexpr int NTHR = 512;
constexpr size_t MiB = 1u << 20;
constexpr size_t WS_CTL = 0, CTL_ZERO_BYTES = 1 * MiB;
constexpr size_t WS_WIN = 2 * MiB, WS_WOUT = 8 * MiB, WS_W1 = 10 * MiB, WS_W2 = 18 * MiB;
constexpr size_t WS_MOD = 26 * MiB, WS_TAB = 26 * MiB + 256 * 1024, WS_SHW1 = 26 * MiB + 512 * 1024;
constexpr size_t WS_H1 = 32 * MiB;
constexpr size_t WS_PROJ = 100 * MiB;
constexpr size_t WS_OF = 304 * MiB, WS_OB = 336 * MiB, WS_HF = 368 * MiB, WS_HB = 400 * MiB;
constexpr size_t WS_MIXED = 32 * MiB;
constexpr size_t WS_A2 = 304 * MiB;
constexpr size_t WS_HID = 32 * MiB;
constexpr size_t WS_END = 432 * MiB;
constexpr int LDS_BYTES = 131072;

__device__ __forceinline__ unsigned pk2(float lo, float hi) { f32x2_t v = {lo, hi}; bf16x2_t b = __builtin_convertvector(v, bf16x2_t); return __builtin_bit_cast(unsigned, b); }
__device__ __forceinline__ bf16 f2bf(float f) { return (bf16)(pk2(f, 0.f) & 0xffffu); }
__device__ __forceinline__ float bflo(unsigned u) { return __uint_as_float(u << 16); }
__device__ __forceinline__ float bfhi(unsigned u) { return __uint_as_float(u & 0xffff0000u); }
__device__ __forceinline__ float sigmoidf_(float x) { return 1.f / (1.f + __expf(-x)); }
__device__ __forceinline__ float wave_sum(float v) {
#pragma unroll
    for (int o = 1; o < 64; o <<= 1) v += __shfl_xor(v, o);
    return v;
}
#define LDS_WAIT() asm volatile("s_waitcnt lgkmcnt(0)" ::: "memory")

struct EpiProj {
    static constexpr bool PERM = true, AFTER_DRAIN = false;
    bf16* O; const float* costab; const float* sintab;
    __device__ __forceinline__ void operator()(const f32x4 (&acc)[2][2][4][2], const pg8::Unit& u, int wr, int wc, int fr, int fq) const {
        const int row0 = u.pm * 256 + wr * 64 + fr; const int type = u.pn >> 1;
        const bool rot = (type <= 1) && (u.pm < MX / 256);
        const float sc = (type == 1) ? 0.08838834764831845f : 1.f;
        const int i0 = (16 * wc + 4 * fq) & 31;
#pragma unroll
        for (int ai = 0; ai < 2; ++ai)
#pragma unroll
            for (int m = 0; m < 4; ++m) {
                const int row = row0 + ai * 128 + m * 16;
                f32x4 cs = {1.f, 1.f, 1.f, 1.f}, sn = {0.f, 0.f, 0.f, 0.f};
                if (rot) { const int t = row & (T - 1); const int pos = (wc < 2) ? (t >> 6) : (t & 63); cs = *(const f32x4*)(costab + pos * 32 + i0); sn = *(const f32x4*)(sintab + pos * 32 + i0); }
                bf16* rowp = O + (size_t)row * NCOL + u.pn * 256 + wc * 32 + 8 * fq;
#pragma unroll
                for (int bj = 0; bj < 2; ++bj) {
                    const f32x4 v0 = acc[ai][bj][m][0], v1 = acc[ai][bj][m][1];
                    const float a0 = v0[0] * cs[0] - v0[1] * sn[0], b0 = v0[1] * cs[0] + v0[0] * sn[0];
                    const float a1 = v0[2] * cs[1] - v0[3] * sn[1], b1 = v0[3] * cs[1] + v0[2] * sn[1];
                    const float a2 = v1[0] * cs[2] - v1[1] * sn[2], b2 = v1[1] * cs[2] + v1[0] * sn[2];
                    const float a3 = v1[2] * cs[3] - v1[3] * sn[3], b3 = v1[3] * cs[3] + v1[2] * sn[3];
                    v4u w; w.x = pk2(a0 * sc, b0 * sc); w.y = pk2(a1 * sc, b1 * sc); w.z = pk2(a2 * sc, b2 * sc); w.w = pk2(a3 * sc, b3 * sc);
                    *(v4u*)(rowp + bj * 128) = w;
                }
            }
    }
};
struct EpiX1 {
    static constexpr bool PERM = false, AFTER_DRAIN = false;
    const float* x; float* x1; bf16* A2; const float* mod; const float* n2g; float* sumsq;
    __device__ __forceinline__ void operator()(const f32x4 (&acc)[2][2][4][2], const pg8::Unit& u, int wr, int wc, int fr, int fq) const {
        const int row0 = u.pm * 256 + wr * 64 + fr; const float* mb = mod + (size_t)(u.pm >> 4) * NMOD;
        const int col0 = u.pn * 256 + wc * 32 + 4 * fq;
        f32x4 gv[2][2], mv[2][2];
#pragma unroll
        for (int bj = 0; bj < 2; ++bj)
#pragma unroll
            for (int n = 0; n < 2; ++n) { const int col = col0 + bj * 128 + n * 16; gv[bj][n] = *(const f32x4*)(mb + 2048 + col);
                const f32x4 s2 = *(const f32x4*)(mb + 4096 + col), g = *(const f32x4*)(n2g + col); mv[bj][n] = g * (s2 + 1.0f); }
#pragma unroll
        for (int ai = 0; ai < 2; ++ai)
#pragma unroll
            for (int m = 0; m < 4; ++m) {
                const int row = row0 + ai * 128 + m * 16; float ss = 0.f;
#pragma unroll
                for (int bj = 0; bj < 2; ++bj)
#pragma unroll
                    for (int n = 0; n < 2; ++n) { const size_t off = (size_t)row * D + col0 + bj * 128 + n * 16;
                        const f32x4 xv = *(const f32x4*)(x + off); const f32x4 v = xv + gv[bj][n] * acc[ai][bj][m][n];
                        *(f32x4*)(x1 + off) = v; ss += (v[0] * v[0] + v[1] * v[1]) + (v[2] * v[2] + v[3] * v[3]);
                        const f32x4 a = v * mv[bj][n]; v2u w; w.x = pk2(a[0], a[1]); w.y = pk2(a[2], a[3]); *(v2u*)(A2 + off) = w; }
                ss += __shfl_xor(ss, 16); ss += __shfl_xor(ss, 32);
                if (fq == 0) atomicAdd(sumsq + row, ss);
            }
    }
};
struct EpiHid {
    static constexpr bool PERM = true, AFTER_DRAIN = false;
    bf16* O; const float* sumsq; const float* shw1;
    __device__ __forceinline__ void operator()(const f32x4 (&acc)[2][2][4][2], const pg8::Unit& u, int wr, int wc, int fr, int fq) const {
        const int row0 = u.pm * 256 + wr * 64 + fr; const int col0 = u.pn * 256 + wc * 32 + 8 * fq;
        const float* sb = shw1 + (size_t)(u.pm >> 4) * FF + col0;
        f32x4 sv[2][2];
#pragma unroll
        for (int bj = 0; bj < 2; ++bj)
#pragma unroll
            for (int n = 0; n < 2; ++n) sv[bj][n] = *(const f32x4*)(sb + bj * 128 + 4 * n);
#pragma unroll
        for (int ai = 0; ai < 2; ++ai)
#pragma unroll
            for (int m = 0; m < 4; ++m) {
                const int row = row0 + ai * 128 + m * 16; const float rs = rsqrtf(sumsq[row] * (1.0f / D) + EPS);
                bf16* rowp = O + (size_t)row * FF + col0;
#pragma unroll
                for (int bj = 0; bj < 2; ++bj) {
                    f32x4 v0 = acc[ai][bj][m][0] * rs + sv[bj][0], v1 = acc[ai][bj][m][1] * rs + sv[bj][1];
#pragma unroll
                    for (int e = 0; e < 4; ++e) { const float p = fmaxf(v0[e], 0.f), q = fmaxf(v1[e], 0.f); v0[e] = p * p; v1[e] = q * q; }
                    v4u w; w.x = pk2(v0[0], v0[1]); w.y = pk2(v0[2], v0[3]); w.z = pk2(v1[0], v1[1]); w.w = pk2(v1[2], v1[3]);
                    *(v4u*)(rowp + bj * 128) = w;
                }
            }
    }
};
struct EpiX2 {
    static constexpr bool PERM = false, AFTER_DRAIN = false;
    float* xio; const float* mod; float* sumsq;
    __device__ __forceinline__ void operator()(const f32x4 (&acc)[2][2][4][2], const pg8::Unit& u, int wr, int wc, int fr, int fq) const {
        const int row0 = u.pm * 256 + wr * 64 + fr; const float* mb = mod + (size_t)(u.pm >> 4) * NMOD;
        const int col0 = u.pn * 256 + wc * 32 + 4 * fq;
        f32x4 gv[2][2];
#pragma unroll
        for (int bj = 0; bj < 2; ++bj)
#pragma unroll
            for (int n = 0; n < 2; ++n) gv[bj][n] = *(const f32x4*)(mb + 5120 + col0 + bj * 128 + n * 16);
#pragma unroll
        for (int ai = 0; ai < 2; ++ai)
#pragma unroll
            for (int m = 0; m < 4; ++m) {
                const int row = row0 + ai * 128 + m * 16; float ss = 0.f;
#pragma unroll
                for (int bj = 0; bj < 2; ++bj)
#pragma unroll
                    for (int n = 0; n < 2; ++n) { const size_t off = (size_t)row * D + col0 + bj * 128 + n * 16;
                        const f32x4 xv = *(const f32x4*)(xio + off); const f32x4 v = xv + gv[bj][n] * acc[ai][bj][m][n];
                        *(f32x4*)(xio + off) = v; ss += (v[0] * v[0] + v[1] * v[1]) + (v[2] * v[2] + v[3] * v[3]); }
                ss += __shfl_xor(ss, 16); ss += __shfl_xor(ss, 32);
                if (fq == 0) atomicAdd(sumsq + row, ss);
            }
    }
};

struct Args { const float* in[21]; float* out; unsigned char* ws; int ph_lo, ph_hi; };
enum { I_X = 0, I_C, I_CTX, I_CCTX, I_WADA, I_BADA, I_N1G, I_N2G, I_WIN, I_RETDEC, I_CONVW, I_CONVB, I_LRUWA, I_LRUBA, I_LRUWX, I_LRUBX, I_LRULAM, I_WOUT, I_W1, I_W2, I_FINALG };

__device__ __forceinline__ void phase_mod(LAS unsigned char* lds, const Args& a) {
    const int tid = threadIdx.x, lane = tid & 63, wave = tid >> 6;
    LAS float* sc = (LAS float*)lds;
    LAS float* red = sc + 9 * 1024;
    float* mod = (float*)(a.ws + WS_MOD);
    for (int i = tid; i < 9 * 1024; i += NTHR) { const float v = (i < 8192) ? a.in[I_C][i] : a.in[I_CCTX][i - 8192]; sc[i] = v / (1.f + __expf(-v)); }
    __syncthreads();
    const float* wada = a.in[I_WADA];
    for (int item = blockIdx.x; item < NMOD / 32; item += gridDim.x) {
        const int col = item * 32 + (lane & 31), kp = lane >> 5;
        float acc[9];
#pragma unroll
        for (int r = 0; r < 9; ++r) acc[r] = 0.f;
#pragma unroll 8
        for (int i = 0; i < 64; ++i) { const int k = wave * 128 + 2 * i + kp; const float w = wada[(size_t)k * NMOD + col];
#pragma unroll
            for (int r = 0; r < 9; ++r) acc[r] += sc[r * 1024 + k] * w; }
#pragma unroll
        for (int r = 0; r < 9; ++r) { acc[r] += __shfl_xor(acc[r], 32); if (lane < 32) red[(wave * 9 + r) * 32 + lane] = acc[r]; }
        __syncthreads();
        if (tid < 288) { const int r = tid >> 5, cl = tid & 31; float s = 0.f;
#pragma unroll
            for (int w = 0; w < 8; ++w) s += red[(w * 9 + r) * 32 + cl];
            mod[r * NMOD + item * 32 + cl] = s + a.in[I_BADA][item * 32 + cl]; }
        __syncthreads();
    }
    if (blockIdx.x == gridDim.x - 1) {
        float* costab = (float*)(a.ws + WS_TAB); float* sintab = costab + 2048;
        for (int i = tid; i < 2048; i += NTHR) {
            const int pos = i >> 5, j = i & 31; double inv = 1.0;
            for (int q = 0; q < j; ++q) inv *= 0.7498942093324559;
            const float ang = (float)pos * (float)inv;
            const int n = (int)rintf(ang * 0.6366197723675814f);
            const double r = (double)ang - (double)n * 1.5707963267948966, r2 = r * r;
            const double sr = r * (1.0 + r2 * (-1.0 / 6 + r2 * (1.0 / 120 + r2 * (-1.0 / 5040 + r2 * (1.0 / 362880 + r2 * (-1.0 / 39916800 + r2 * (1.0 / 6227020800.0)))))));
            const double cr = 1.0 + r2 * (-0.5 + r2 * (1.0 / 24 + r2 * (-1.0 / 720 + r2 * (1.0 / 40320 + r2 * (-1.0 / 3628800 + r2 * (1.0 / 479001600 + r2 * (-1.0 / 87178291200.0)))))));
            const int qd = n & 3; const double c = (qd == 0) ? cr : (qd == 1) ? -sr : (qd == 2) ? -cr : sr, s = (qd == 0) ? sr : (qd == 1) ? cr : (qd == 2) ? -sr : -cr;
            costab[i] = (float)c; sintab[i] = (float)s;
        }
    }
}

template <bool PERMQK>
__device__ __forceinline__ void transpose_item(const float* W, int K, int N, bf16* WT, LAS float* scr, int item, int lane) {
    const int nblk = N / 32, kb = item / nblk, nb = item % nblk, k0 = 64 * kb, n0 = 32 * nb;
    int ns = n0 + (lane & 31);
    if (PERMQK && ns < 1024) { const int p = ns & 127; ns = (ns & ~127) + (p >> 1) + 64 * (p & 1); }
#pragma unroll 8
    for (int i = 0; i < 32; ++i) { const int kk = 2 * i + (lane >> 5); scr[kk * 33 + (lane & 31)] = W[(size_t)(k0 + kk) * N + ns]; }
    LDS_WAIT(); asm volatile("" ::: "memory");
    const int c = lane & 7;
#pragma unroll
    for (int j = 0; j < 4; ++j) { const int n = (lane >> 3) + 8 * j; const LAS float* s = scr + (8 * c) * 33 + n;
        v4u o; o.x = pk2(s[0 * 33], s[1 * 33]); o.y = pk2(s[2 * 33], s[3 * 33]); o.z = pk2(s[4 * 33], s[5 * 33]); o.w = pk2(s[6 * 33], s[7 * 33]);
        *(v4u*)(WT + (size_t)(n0 + n) * K + k0 + 8 * c) = o; }
    LDS_WAIT(); asm volatile("" ::: "memory");
}
__device__ __forceinline__ void phase_prep(LAS unsigned char* lds, const Args& a) {
    const int tid = threadIdx.x, lane = tid & 63, wave = tid >> 6;
    LAS float* scr = (LAS float*)(lds + wave * 16384);
    const int gw = blockIdx.x * 8 + wave, NGW = gridDim.x * 8;
    constexpr int I_IN = (D / 64) * (NCOL / 32), I_O = (D / 64) * (D / 32), I_1 = (D / 64) * (FF / 32), I_2 = (FF / 64) * (D / 32);
    for (int it = gw; it < I_IN + I_O + I_1 + I_2; it += NGW) {
        int r = it;
        if (r < I_IN) { transpose_item<true>(a.in[I_WIN], D, NCOL, (bf16*)(a.ws + WS_WIN), scr, r, lane); continue; } r -= I_IN;
        if (r < I_O) { transpose_item<false>(a.in[I_WOUT], D, D, (bf16*)(a.ws + WS_WOUT), scr, r, lane); continue; } r -= I_O;
        if (r < I_1) { transpose_item<false>(a.in[I_W1], D, FF, (bf16*)(a.ws + WS_W1), scr, r, lane); continue; } r -= I_1;
        transpose_item<false>(a.in[I_W2], FF, D, (bf16*)(a.ws + WS_W2), scr, r, lane);
    }
    const float* mod = (const float*)(a.ws + WS_MOD); const float* n1g = a.in[I_N1G]; bf16* H1 = (bf16*)(a.ws + WS_H1);
    for (int m = gw; m < MTOT; m += NGW) {
        const float* xrow = (m < MX) ? a.in[I_X] + (size_t)m * D : a.in[I_CTX] + (size_t)(m - MX) * D;
        const float* mb = mod + (size_t)((m < MX) ? (m >> 12) : 8) * NMOD;
        f32x4 v[4]; float s = 0.f;
#pragma unroll
        for (int j = 0; j < 4; ++j) { v[j] = *(const f32x4*)(xrow + 256 * j + 4 * lane); s += (v[j][0] * v[j][0] + v[j][1] * v[j][1]) + (v[j][2] * v[j][2] + v[j][3] * v[j][3]); }
        const float rs = rsqrtf(wave_sum(s) * (1.0f / D) + EPS);
#pragma unroll
        for (int j = 0; j < 4; ++j) { const int col = 256 * j + 4 * lane;
            const f32x4 g = *(const f32x4*)(n1g + col), sh = *(const f32x4*)(mb + col), sc = *(const f32x4*)(mb + 1024 + col);
            const f32x4 o = (v[j] * rs) * g * (sc + 1.0f) + sh; v2u w; w.x = pk2(o[0], o[1]); w.y = pk2(o[2], o[3]);
            *(v2u*)(H1 + (size_t)m * D + col) = w; }
    }
}

__device__ __forceinline__ s16x4 trr(const LAS unsigned char* p) { return __builtin_bit_cast(s16x4, __builtin_amdgcn_ds_read_tr16_b64_v4i16((LAS v4i16_t*)p)); }
__device__ __forceinline__ bf16x8 cat8(s16x4 x, s16x4 y) { return __builtin_shufflevector(x, y, 0, 1, 2, 3, 4, 5, 6, 7); }
#define MFMA16(a_, b_, c_) __builtin_amdgcn_mfma_f32_16x16x32_bf16(a_, b_, c_, 0, 0, 0)
constexpr int KS_STRIDE = 272, V_STRIDE = 80, ST_STRIDE = 272;
constexpr int RL_KS = 0, RL_VS = 128 * KS_STRIDE, RL_VW = RL_VS + 128 * V_STRIDE, RL_ST = RL_VW + 128 * V_STRIDE, RL_ST_BYTES = 32 * ST_STRIDE;
static_assert(RL_ST + 2 * RL_ST_BYTES <= LDS_BYTES, "retention LDS map");

__device__ __forceinline__ void ret_item(LAS unsigned char* lds, const bf16* __restrict__ PROJ, bf16* __restrict__ OF, bf16* __restrict__ OB, const float* ret_decay, int item) {
    const int tid = threadIdx.x, lane = tid & 63, w = __builtin_amdgcn_readfirstlane(tid >> 6), fr = lane & 15, quad = lane >> 4, q4 = fr >> 2, p4 = fr & 3;
    const int es = item & 3, dir = (item >> 2) & 1, h = (item >> 3) & 3, b = item >> 5;
    const float xd = ret_decay[dir * 4 + h];
    const float lg = fminf(xd, 0.f) - log1pf(__expf(-fabsf(xd)));
    const float l2g = lg * 1.4426950408889634f;
    const float G = exp2f(l2g * 128.f);
    bf16* Od = dir ? OB : OF;
    LAS unsigned char* Ks = lds + RL_KS; LAS unsigned char* Vs = lds + RL_VS; LAS unsigned char* Vw = lds + RL_VW; LAS unsigned char* St = lds + RL_ST;
    const int kr = tid >> 4, kc = tid & 15, vr = tid >> 2, vc = tid & 3;
    const float wsv = exp2f(l2g * (float)(dir ? vr : 127 - vr));
    v4u kreg[4], vreg, qreg[4];
#define RET_ROWBASE(ci) ((ci) < 2 ? (MX + b * CTXL + (dir ? 1 - (ci) : (ci)) * 128) : (b * T + (dir ? 33 - (ci) : (ci) - 2) * 128))
#define RET_LOAD(ci) do { const int rb_ = RET_ROWBASE(ci); const bf16* kp_ = PROJ + (size_t)(rb_ + kr) * NCOL + 512 + h * 128 + kc * 8; \
        _Pragma("unroll") for (int i_ = 0; i_ < 4; ++i_) kreg[i_] = *(const v4u*)(kp_ + (size_t)i_ * 32 * NCOL); \
        vreg = *(const v4u*)(PROJ + (size_t)(rb_ + vr) * NCOL + 1024 + h * 128 + es * 32 + vc * 8); \
        if ((ci) >= 2) { const bf16* qp_ = PROJ + (size_t)(rb_ + 16 * w + fr) * NCOL + h * 128 + 8 * quad; \
            _Pragma("unroll") for (int s_ = 0; s_ < 4; ++s_) qreg[s_] = *(const v4u*)(qp_ + 32 * s_); } } while (0)
    f32x4 S0 = {0.f, 0.f, 0.f, 0.f}, S1 = {0.f, 0.f, 0.f, 0.f};
#pragma unroll
    for (int s_ = 0; s_ < 4; ++s_) qreg[s_] = (v4u){0u, 0u, 0u, 0u};
    RET_LOAD(0);
    for (int ci = 0; ci < 34; ++ci) {
#pragma unroll
        for (int i = 0; i < 4; ++i) *(LAS v4u*)(Ks + (kr + 32 * i) * KS_STRIDE + kc * 16) = kreg[i];
        *(LAS v4u*)(Vs + vr * V_STRIDE + vc * 16) = vreg;
        { v4u s; s.x = pk2(bflo(vreg.x) * wsv, bfhi(vreg.x) * wsv); s.y = pk2(bflo(vreg.y) * wsv, bfhi(vreg.y) * wsv); s.z = pk2(bflo(vreg.z) * wsv, bfhi(vreg.z) * wsv); s.w = pk2(bflo(vreg.w) * wsv, bfhi(vreg.w) * wsv);
          *(LAS v4u*)(Vw + vr * V_STRIDE + vc * 16) = s; }
        bf16x8 qf[4];
#pragma unroll
        for (int s_ = 0; s_ < 4; ++s_) qf[s_] = __builtin_bit_cast(bf16x8, qreg[s_]);
        const int rb = RET_ROWBASE(ci);
        if (ci + 1 < 34) RET_LOAD(ci + 1);
        __syncthreads();
        const LAS unsigned char* Stc = St + (ci & 1) * RL_ST_BYTES; LAS unsigned char* Stn = St + ((ci + 1) & 1) * RL_ST_BYTES;
        if (ci >= 2) {
            bf16x8 pf[4];
            const int c = 16 * w + fr;
#pragma unroll
            for (int kp = 0; kp < 4; ++kp) {
                f32x4 s0 = {0.f, 0.f, 0.f, 0.f}, s1 = {0.f, 0.f, 0.f, 0.f};
#pragma unroll
                for (int ks = 0; ks < 4; ++ks) {
                    const bf16x8 a0 = *(const LAS bf16x8*)(Ks + (32 * kp + fr) * KS_STRIDE + (32 * ks + 8 * quad) * 2);
                    const bf16x8 a1 = *(const LAS bf16x8*)(Ks + (32 * kp + 16 + fr) * KS_STRIDE + (32 * ks + 8 * quad) * 2);
                    s0 = MFMA16(a0, qf[ks], s0); s1 = MFMA16(a1, qf[ks], s1);
                }
#pragma unroll
                for (int j = 0; j < 4; ++j) { const int m0 = 32 * kp + 4 * quad + j, m1 = m0 + 16; const int r0 = dir ? (m0 - c) : (c - m0), r1 = dir ? (m1 - c) : (c - m1);
                    s0[j] *= (r0 >= 0) ? exp2f(l2g * (float)r0) : 0.f; s1[j] *= (r1 >= 0) ? exp2f(l2g * (float)r1) : 0.f; }
                v4u pw; pw.x = pk2(s0[0], s0[1]); pw.y = pk2(s0[2], s0[3]); pw.z = pk2(s1[0], s1[1]); pw.w = pk2(s1[2], s1[3]);
                pf[kp] = __builtin_bit_cast(bf16x8, pw);
            }
            f32x4 o0 = {0.f, 0.f, 0.f, 0.f}, o1 = {0.f, 0.f, 0.f, 0.f};
#pragma unroll
            for (int ks = 0; ks < 4; ++ks) {
                const bf16x8 b0 = *(const LAS bf16x8*)(Stc + fr * ST_STRIDE + (32 * ks + 8 * quad) * 2);
                const bf16x8 b1 = *(const LAS bf16x8*)(Stc + (16 + fr) * ST_STRIDE + (32 * ks + 8 * quad) * 2);
                o0 = MFMA16(qf[ks], b0, o0); o1 = MFMA16(qf[ks], b1, o1);
            }
#pragma unroll
            for (int j = 0; j < 4; ++j) { const int cc = 16 * w + 4 * quad + j; const float wq = exp2f(l2g * (float)(dir ? 128 - cc : cc + 1)); o0[j] *= wq; o1[j] *= wq; }
#pragma unroll
            for (int kp = 0; kp < 4; ++kp) {
                const LAS unsigned char* vb = Vs + (32 * kp + 4 * quad + q4) * V_STRIDE + 8 * p4;
                const bf16x8 bv0 = cat8(trr(vb), trr(vb + 16 * V_STRIDE));
                const bf16x8 bv1 = cat8(trr(vb + 32), trr(vb + 16 * V_STRIDE + 32));
                o0 = MFMA16(pf[kp], bv0, o0); o1 = MFMA16(pf[kp], bv1, o1);
            }
#pragma unroll
            for (int j = 0; j < 4; ++j) { bf16* op = Od + (size_t)(rb + 16 * w + 4 * quad + j) * 512 + h * 128 + es * 32 + fr; op[0] = f2bf(o0[j]); op[16] = f2bf(o1[j]); }
        }
        S0 *= G; S1 *= G;
#pragma unroll
        for (int ks = 0; ks < 4; ++ks) {
            const int r0 = 32 * ks + 8 * quad + q4;
            const LAS unsigned char* kb = Ks + r0 * KS_STRIDE + (16 * w + 4 * p4) * 2;
            const bf16x8 af = cat8(trr(kb), trr(kb + 4 * KS_STRIDE));
            const LAS unsigned char* vb = Vw + r0 * V_STRIDE + 8 * p4;
            const bf16x8 bv0 = cat8(trr(vb), trr(vb + 4 * V_STRIDE));
            const bf16x8 bv1 = cat8(trr(vb + 32), trr(vb + 4 * V_STRIDE + 32));
            S0 = MFMA16(af, bv0, S0); S1 = MFMA16(af, bv1, S1);
        }
        { v2u s; s.x = pk2(S0[0], S0[1]); s.y = pk2(S0[2], S0[3]); *(LAS v2u*)(Stn + fr * ST_STRIDE + (16 * w + 4 * quad) * 2) = s;
          s.x = pk2(S1[0], S1[1]); s.y = pk2(S1[2], S1[3]); *(LAS v2u*)(Stn + (16 + fr) * ST_STRIDE + (16 * w + 4 * quad) * 2) = s; }
        __syncthreads();
    }
#undef RET_LOAD
#undef RET_ROWBASE
}

constexpr int LL_XR = 0, LL_XC = 132 * 128, LL_XCF = LL_XC + 128 * 144, LL_WAT = LL_XCF + 128 * 32 * 4, LL_WXT = LL_WAT + 32 * 144, LL_AS = LL_WXT + 32 * 144, LL_BS = LL_AS + 128 * 32 * 4,
              LL_SEGA = LL_BS + 128 * 32 * 4, LL_SEGB = LL_SEGA + 16 * 32 * 4, LL_HST = LL_SEGB + 16 * 32 * 4, LL_END = LL_HST + 2 * 32 * 4;
static_assert(LL_END <= LDS_BYTES, "lru LDS map");
__device__ __forceinline__ void lru_item(LAS unsigned char* lds, const bf16* __restrict__ PROJ, bf16* __restrict__ HF, bf16* __restrict__ HB, const Args& a, int item) {
    const int tid = threadIdx.x, lane = tid & 63, w = __builtin_amdgcn_readfirstlane(tid >> 6), fr = lane & 15, quad = lane >> 4;
    const int half = item & 1, dir = (item >> 1) & 1, nb = (item >> 2) & 7, b = item >> 5;
    bf16* Hd = dir ? HB : HF;
    LAS unsigned char* XR = lds + LL_XR; LAS unsigned char* XC = lds + LL_XC; LAS float* XCF = (LAS float*)(lds + LL_XCF);
    LAS bf16* WAT = (LAS bf16*)(lds + LL_WAT); LAS bf16* WXT = (LAS bf16*)(lds + LL_WXT);
    LAS float* As = (LAS float*)(lds + LL_AS); LAS float* Bs = (LAS float*)(lds + LL_BS); LAS float* segA = (LAS float*)(lds + LL_SEGA); LAS float* segB = (LAS float*)(lds + LL_SEGB);
    LAS float* hst = (LAS float*)(lds + LL_HST);
    { const float* wa = a.in[I_LRUWA] + (size_t)(dir * 8 + nb) * 4096; const float* wx = a.in[I_LRUWX] + (size_t)(dir * 8 + nb) * 4096;
      for (int i = tid; i < 2048; i += NTHR) { const int e = i & 31, d = i >> 5; WAT[e * 72 + d] = f2bf(wa[d * 64 + 32 * half + e]); WXT[e * 72 + d] = f2bf(wx[d * 64 + 32 * half + e]); }
      if (tid < 64) hst[tid] = 0.f; }
    const int ch0 = nb * 64 + 32 * half + fr;
    const float ba0 = a.in[I_LRUBA][dir * 512 + ch0], ba1 = a.in[I_LRUBA][dir * 512 + ch0 + 16], bx0 = a.in[I_LRUBX][dir * 512 + ch0], bx1 = a.in[I_LRUBX][dir * 512 + ch0 + 16];
    float sp0, sp1; { const float l0 = -a.in[I_LRULAM][dir * 512 + ch0], l1 = -a.in[I_LRULAM][dir * 512 + ch0 + 16];
        sp0 = fmaxf(l0, 0.f) + log1pf(__expf(-fabsf(l0))); sp1 = fmaxf(l1, 0.f) + log1pf(__expf(-fabsf(l1))); }
    const int dg = tid & 7, ct = tid >> 3;
    float cw[4][8], cb[8];
#pragma unroll
    for (int e = 0; e < 8; ++e) { const int chn = nb * 64 + dg * 8 + e; cb[e] = a.in[I_CONVB][chn];
#pragma unroll
        for (int j = 0; j < 4; ++j) cw[j][e] = a.in[I_CONVW][j * 512 + chn]; }
    v4u xreg[3];
#define LRU_SEG(ti, segrow0, L, t0) const int segrow0 = ((ti) < 2) ? (MX + b * CTXL) : (b * T); const int L = ((ti) < 2) ? CTXL : T; \
        const int t0 = (((ti) < 2) ? (dir ? 1 - (ti) : (ti)) : (dir ? 33 - (ti) : (ti) - 2)) * 128;
#define LRU_LOAD(ti) do { LRU_SEG(ti, sr_, L_, t0_) \
        _Pragma("unroll") for (int i_ = 0; i_ < 3; ++i_) { const int p_ = tid + NTHR * i_; const int lr_ = p_ >> 3, c8_ = p_ & 7; const int ts_ = t0_ - 1 + lr_; \
            xreg[i_] = (p_ < 1056 && ts_ >= 0 && ts_ < L_) ? *(const v4u*)(PROJ + (size_t)(sr_ + ts_) * NCOL + 2048 + nb * 64 + c8_ * 8) : (v4u){0u, 0u, 0u, 0u}; } } while (0)
    LRU_LOAD(0);
    for (int ti = 0; ti < 34; ++ti) {
#pragma unroll
        for (int i = 0; i < 3; ++i) { const int p = tid + NTHR * i; if (p < 1056) *(LAS v4u*)(XR + (p >> 3) * 128 + (p & 7) * 16) = xreg[i]; }
        LRU_SEG(ti, segrow0, L, t0)
        (void)L;
        if (ti + 1 < 34) LRU_LOAD(ti + 1);
        __syncthreads();
#pragma unroll
        for (int u = 0; u < 2; ++u) {
            const int tl = ct + 64 * u; float o[8];
#pragma unroll
            for (int e = 0; e < 8; ++e) o[e] = cb[e];
#pragma unroll
            for (int j = 0; j < 4; ++j) { const v4u r = *(const LAS v4u*)(XR + (tl + j) * 128 + dg * 16);
                o[0] += bflo(r.x) * cw[j][0]; o[1] += bfhi(r.x) * cw[j][1]; o[2] += bflo(r.y) * cw[j][2]; o[3] += bfhi(r.y) * cw[j][3];
                o[4] += bflo(r.z) * cw[j][4]; o[5] += bfhi(r.z) * cw[j][5]; o[6] += bflo(r.w) * cw[j][6]; o[7] += bfhi(r.w) * cw[j][7]; }
            v4u pw; pw.x = pk2(o[0], o[1]); pw.y = pk2(o[2], o[3]); pw.z = pk2(o[4], o[5]); pw.w = pk2(o[6], o[7]);
            *(LAS v4u*)(XC + tl * 144 + dg * 16) = pw;
            if ((dg >> 2) == half) { LAS float* xf = XCF + tl * 32 + (dg & 3) * 8; *(LAS f32x4*)xf = (f32x4){o[0], o[1], o[2], o[3]}; *(LAS f32x4*)(xf + 4) = (f32x4){o[4], o[5], o[6], o[7]}; }
        }
        __syncthreads();
        {
            f32x4 ra0 = {0.f, 0.f, 0.f, 0.f}, ra1 = ra0, rx0 = ra0, rx1 = ra0;
#pragma unroll
            for (int ks = 0; ks < 2; ++ks) {
                const bf16x8 af = *(const LAS bf16x8*)(XC + (16 * w + fr) * 144 + (32 * ks + 8 * quad) * 2);
                const bf16x8 wa0 = *(const LAS bf16x8*)((const LAS unsigned char*)WAT + fr * 144 + (32 * ks + 8 * quad) * 2);
                const bf16x8 wa1 = *(const LAS bf16x8*)((const LAS unsigned char*)WAT + (16 + fr) * 144 + (32 * ks + 8 * quad) * 2);
                const bf16x8 wx0 = *(const LAS bf16x8*)((const LAS unsigned char*)WXT + fr * 144 + (32 * ks + 8 * quad) * 2);
                const bf16x8 wx1 = *(const LAS bf16x8*)((const LAS unsigned char*)WXT + (16 + fr) * 144 + (32 * ks + 8 * quad) * 2);
                ra0 = MFMA16(af, wa0, ra0); ra1 = MFMA16(af, wa1, ra1); rx0 = MFMA16(af, wx0, rx0); rx1 = MFMA16(af, wx1, rx1);
            }
#pragma unroll
            for (int j = 0; j < 4; ++j) {
                const int t = 16 * w + 4 * quad + j;
                { const float r = sigmoidf_(ra0[j] + ba0), ig = sigmoidf_(rx0[j] + bx0), la = -8.f * r * sp0; const float av = __expf(la), mult = sqrtf(-expm1f(2.f * la));
                  As[t * 32 + fr] = av; Bs[t * 32 + fr] = mult * ig * XCF[t * 32 + fr]; }
                { const float r = sigmoidf_(ra1[j] + ba1), ig = sigmoidf_(rx1[j] + bx1), la = -8.f * r * sp1; const float av = __expf(la), mult = sqrtf(-expm1f(2.f * la));
                  As[t * 32 + 16 + fr] = av; Bs[t * 32 + 16 + fr] = mult * ig * XCF[t * 32 + 16 + fr]; }
            }
        }
        __syncthreads();
        {
            const int seg = tid >> 5, el = tid & 31;
            float av[8], xv[8];
#pragma unroll
            for (int k = 0; k < 8; ++k) { const int pi = 8 * seg + k, t = dir ? 127 - pi : pi; av[k] = As[t * 32 + el]; xv[k] = Bs[t * 32 + el]; }
            float Ap = 1.f, Bp = 0.f;
#pragma unroll
            for (int k = 0; k < 8; ++k) { Bp = av[k] * Bp + xv[k]; Ap *= av[k]; }
            segA[seg * 32 + el] = Ap; segB[seg * 32 + el] = Bp;
            __syncthreads();
            float hv = hst[(ti & 1) * 32 + el];
            for (int s = 0; s < seg; ++s) hv = segA[s * 32 + el] * hv + segB[s * 32 + el];
#pragma unroll
            for (int k = 0; k < 8; ++k) { hv = av[k] * hv + xv[k];
                if (ti >= 2) { const int pi = 8 * seg + k, t = dir ? 127 - pi : pi; Hd[(size_t)(segrow0 + t0 + t) * 512 + nb * 64 + 32 * half + el] = f2bf(hv); } }
            if (seg == 15) hst[((ti + 1) & 1) * 32 + el] = hv;
        }
        __syncthreads();
    }
#undef LRU_LOAD
#undef LRU_SEG
}

__device__ __forceinline__ float gelu_tanh(float x) { const float u = 0.7978845608028654f * (x + 0.044715f * x * x * x); const float e = __expf(2.f * u); const float th = 1.f - 2.f / (e + 1.f); return 0.5f * x * (1.f + th); }
__device__ __forceinline__ void phase_mix(const Args& a) {
    const int tid = threadIdx.x, lane = tid & 63, wave = tid >> 6;
    const int gw = blockIdx.x * 8 + wave, NGW = gridDim.x * 8;
    const float* mod = (const float*)(a.ws + WS_MOD);
    { const bf16* W1t = (const bf16*)(a.ws + WS_W1); float* shw1 = (float*)(a.ws + WS_SHW1);
      for (int col = gw; col < FF; col += NGW) {
          const v4u w0 = *(const v4u*)(W1t + (size_t)col * D + 16 * lane), w1 = *(const v4u*)(W1t + (size_t)col * D + 16 * lane + 8);
          float wf[16]; wf[0] = bflo(w0.x); wf[1] = bfhi(w0.x); wf[2] = bflo(w0.y); wf[3] = bfhi(w0.y); wf[4] = bflo(w0.z); wf[5] = bfhi(w0.z); wf[6] = bflo(w0.w); wf[7] = bfhi(w0.w);
          wf[8] = bflo(w1.x); wf[9] = bfhi(w1.x); wf[10] = bflo(w1.y); wf[11] = bfhi(w1.y); wf[12] = bflo(w1.z); wf[13] = bfhi(w1.z); wf[14] = bflo(w1.w); wf[15] = bfhi(w1.w);
#pragma unroll
          for (int bb = 0; bb < NB; ++bb) { const float* sh = mod + (size_t)bb * NMOD + 3072 + 16 * lane; float s = 0.f;
#pragma unroll
              for (int q = 0; q < 4; ++q) { const f32x4 v = *(const f32x4*)(sh + 4 * q); s += v[0] * wf[4 * q] + v[1] * wf[4 * q + 1] + v[2] * wf[4 * q + 2] + v[3] * wf[4 * q + 3]; }
              s = wave_sum(s); if (lane == 0) shw1[bb * FF + col] = s; }
      } }
    const bf16* PROJ = (const bf16*)(a.ws + WS_PROJ); const bf16* OF = (const bf16*)(a.ws + WS_OF); const bf16* OB = (const bf16*)(a.ws + WS_OB);
    const bf16* HF = (const bf16*)(a.ws + WS_HF); const bf16* HB = (const bf16*)(a.ws + WS_HB); bf16* MIXED = (bf16*)(a.ws + WS_MIXED);
    for (int row = gw; row < MX; row += NGW) {
        const v4u of = *(const v4u*)(OF + (size_t)row * 512 + 8 * lane), ob = *(const v4u*)(OB + (size_t)row * 512 + 8 * lane);
        const v4u gg = *(const v4u*)(PROJ + (size_t)row * NCOL + 1536 + 8 * lane);
        const v4u hf = *(const v4u*)(HF + (size_t)row * 512 + 8 * lane), hb = *(const v4u*)(HB + (size_t)row * 512 + 8 * lane);
        const v4u gt = *(const v4u*)(PROJ + (size_t)row * NCOL + 2560 + 8 * lane);
        float o[8]; o[0] = bflo(of.x) + bflo(ob.x); o[1] = bfhi(of.x) + bfhi(ob.x); o[2] = bflo(of.y) + bflo(ob.y); o[3] = bfhi(of.y) + bfhi(ob.y);
        o[4] = bflo(of.z) + bflo(ob.z); o[5] = bfhi(of.z) + bfhi(ob.z); o[6] = bflo(of.w) + bflo(ob.w); o[7] = bfhi(of.w) + bfhi(ob.w);
        float s = ((o[0] + o[1]) + (o[2] + o[3])) + ((o[4] + o[5]) + (o[6] + o[7]));
        s += __shfl_xor(s, 1); s += __shfl_xor(s, 2); s += __shfl_xor(s, 4); s += __shfl_xor(s, 8);
        const float mu = s * (1.0f / 128.0f); float q = 0.f;
#pragma unroll
        for (int e = 0; e < 8; ++e) { o[e] -= mu; q += o[e] * o[e]; }
        q += __shfl_xor(q, 1); q += __shfl_xor(q, 2); q += __shfl_xor(q, 4); q += __shfl_xor(q, 8);
        const float rstd = rsqrtf(q * (1.0f / 128.0f) + EPS);
        float g[8]; g[0] = bflo(gg.x); g[1] = bfhi(gg.x); g[2] = bflo(gg.y); g[3] = bfhi(gg.y); g[4] = bflo(gg.z); g[5] = bfhi(gg.z); g[6] = bflo(gg.w); g[7] = bfhi(gg.w);
#pragma unroll
        for (int e = 0; e < 8; ++e) o[e] = o[e] * rstd * (g[e] / (1.f + __expf(-g[e])));
        v4u w; w.x = pk2(o[0], o[1]); w.y = pk2(o[2], o[3]); w.z = pk2(o[4], o[5]); w.w = pk2(o[6], o[7]);
        *(v4u*)(MIXED + (size_t)row * D + 8 * lane) = w;
        float hh[8]; hh[0] = bflo(hf.x) + bflo(hb.x); hh[1] = bfhi(hf.x) + bfhi(hb.x); hh[2] = bflo(hf.y) + bflo(hb.y); hh[3] = bfhi(hf.y) + bfhi(hb.y);
        hh[4] = bflo(hf.z) + bflo(hb.z); hh[5] = bfhi(hf.z) + bfhi(hb.z); hh[6] = bflo(hf.w) + bflo(hb.w); hh[7] = bfhi(hf.w) + bfhi(hb.w);
        g[0] = bflo(gt.x); g[1] = bfhi(gt.x); g[2] = bflo(gt.y); g[3] = bfhi(gt.y); g[4] = bflo(gt.z); g[5] = bfhi(gt.z); g[6] = bflo(gt.w); g[7] = bfhi(gt.w);
#pragma unroll
        for (int e = 0; e < 8; ++e) hh[e] *= gelu_tanh(g[e]);
        w.x = pk2(hh[0], hh[1]); w.y = pk2(hh[2], hh[3]); w.z = pk2(hh[4], hh[5]); w.w = pk2(hh[6], hh[7]);
        *(v4u*)(MIXED + (size_t)row * D + 512 + 8 * lane) = w;
    }
}

__device__ __forceinline__ void phase_final(const Args& a) {
    const int tid = threadIdx.x, lane = tid & 63, wave = tid >> 6;
    const int gw = blockIdx.x * 8 + wave, NGW = gridDim.x * 8;
    const float* sumsq2 = (const float*)(a.ws + WS_CTL) + MX; const float* fg = a.in[I_FINALG];
    f32x4 g[4];
#pragma unroll
    for (int j = 0; j < 4; ++j) g[j] = *(const f32x4*)(fg + 256 * j + 4 * lane);
    for (int row = gw; row < MX; row += NGW) {
        const float rs = rsqrtf(sumsq2[row] * (1.0f / D) + EPS);
        float* p = a.out + (size_t)row * D + 4 * lane;
#pragma unroll
        for (int j = 0; j < 4; ++j) { const f32x4 v = *(const f32x4*)(p + 256 * j); *(f32x4*)(p + 256 * j) = v * rs * g[j]; }
    }
}

__global__ void __launch_bounds__(NTHR, 2) fwd_kernel(Args a) {
    extern __shared__ __attribute__((aligned(16))) unsigned char lds_raw[];
    LAS unsigned char* lds = (LAS unsigned char*)lds_raw;
    cg::grid_group grid = cg::this_grid();
    const int lo = a.ph_lo, hi = a.ph_hi;
#define IN(k) (lo <= (k) && (k) < hi)
#define SEAM(k) do { if (IN(k) && IN((k) + 1)) grid.sync(); } while (0)
    float* sumsq1 = (float*)(a.ws + WS_CTL); float* sumsq2 = sumsq1 + MX;
    const float* mod = (const float*)(a.ws + WS_MOD);
    if (IN(0)) phase_mod(lds, a);
    SEAM(0);
    if (IN(1)) phase_prep(lds, a);
    SEAM(1);
    if (IN(2)) {
        pg8::Gemm g{(const bf16*)(a.ws + WS_H1), (const bf16*)(a.ws + WS_WIN), MTOT, NCOL, D}; pg8::StaticOrder S; S.init(MTOT, NCOL, (int)gridDim.x, (int)blockIdx.x);
        EpiProj E{(bf16*)(a.ws + WS_PROJ), (const float*)(a.ws + WS_TAB), (const float*)(a.ws + WS_TAB) + 2048};
        pg8::gemm_phase<EpiProj, pg8::StaticOrder, true, true>(lds, g, S, E);
    }
    SEAM(2);
    if (IN(3)) {
        const bf16* PROJ = (const bf16*)(a.ws + WS_PROJ);
        for (int it = blockIdx.x; it < 512; it += gridDim.x) {
            if (it < 256) ret_item(lds, PROJ, (bf16*)(a.ws + WS_OF), (bf16*)(a.ws + WS_OB), a.in[I_RETDEC], it);
            else lru_item(lds, PROJ, (bf16*)(a.ws + WS_HF), (bf16*)(a.ws + WS_HB), a, it - 256);
            __syncthreads();
        }
    }
    SEAM(3);
    if (IN(4)) phase_mix(a);
    SEAM(4);
    if (IN(5)) {
        pg8::Gemm g{(const bf16*)(a.ws + WS_MIXED), (const bf16*)(a.ws + WS_WOUT), MX, D, D}; pg8::StaticOrder S; S.init(MX, D, (int)gridDim.x, (int)blockIdx.x);
        EpiX1 E{a.in[I_X], a.out, (bf16*)(a.ws + WS_A2), mod, a.in[I_N2G], sumsq1};
        pg8::gemm_phase<EpiX1, pg8::StaticOrder, true, true>(lds, g, S, E);
    }
    SEAM(5);
    if (IN(6)) {
        pg8::Gemm g{(const bf16*)(a.ws + WS_A2), (const bf16*)(a.ws + WS_W1), MX, FF, D}; pg8::StaticOrder S; S.init(MX, FF, (int)gridDim.x, (int)blockIdx.x);
        EpiHid E{(bf16*)(a.ws + WS_HID), sumsq1, (const float*)(a.ws + WS_SHW1)};
        pg8::gemm_phase<EpiHid, pg8::StaticOrder, true, true>(lds, g, S, E);
    }
    SEAM(6);
    if (IN(7)) {
        pg8::Gemm g{(const bf16*)(a.ws + WS_HID), (const bf16*)(a.ws + WS_W2), MX, D, FF}; pg8::StaticOrder S; S.init(MX, D, (int)gridDim.x, (int)blockIdx.x);
        EpiX2 E{a.out, mod, sumsq2};
        pg8::gemm_phase<EpiX2, pg8::StaticOrder, true, true>(lds, g, S, E);
    }
    SEAM(7);
    if (IN(8)) phase_final(a);
#undef IN
#undef SEAM
}

extern "C" void kernel_launch(void* const* d_in, const int* in_sizes, int n_in, void* d_out, int out_size, void* d_ws, size_t ws_size, hipStream_t stream) {
    static int grid = 0;
    if (grid == 0) {
        if (n_in != 21 || in_sizes[0] != MX * D || out_size != MX * D || ws_size < WS_END) { fprintf(stderr, "kernel_launch: unexpected shapes (n_in %d, ws %zu)\n", n_in, ws_size); grid = -1; return; }
        int dev = 0, cus = 0, per_cu = 0;
        hipGetDevice(&dev); hipDeviceGetAttribute(&cus, hipDeviceAttributeMultiprocessorCount, dev);
        hipFuncSetAttribute((const void*)fwd_kernel, hipFuncAttributeMaxDynamicSharedMemorySize, LDS_BYTES);
        hipOccupancyMaxActiveBlocksPerMultiprocessor(&per_cu, (const void*)fwd_kernel, NTHR, LDS_BYTES);
        if (per_cu < 1) { fprintf(stderr, "kernel_launch: occupancy query says %d blocks per CU\n", per_cu); per_cu = 1; }
        (void)hipGetLastError();
        grid = cus * per_cu;
        if (grid > 512) grid = 512;
    }
    if (grid < 0) return;
    hipMemsetAsync((char*)d_ws + WS_CTL, 0, CTL_ZERO_BYTES, stream);
    Args a{};
    for (int i = 0; i < 21; ++i) a.in[i] = (const float*)d_in[i];
    a.out = (float*)d_out; a.ws = (unsigned char*)d_ws;
#if MK_N_LAUNCHES == 1
    a.ph_lo = 0; a.ph_hi = 9;
    void* args[] = {&a};
    hipError_t e = hipLaunchCooperativeKernel((const void*)fwd_kernel, dim3(grid), dim3(NTHR), args, LDS_BYTES, stream);
    if (e != hipSuccess) fprintf(stderr, "cooperative launch failed: %s (grid %d)\n", hipGetErrorString(e), grid);
#else
    for (int p = 0; p < 9; ++p) { a.ph_lo = p; a.ph_hi = p + 1; hipLaunchKernelGGL(fwd_kernel, dim3(grid), dim3(NTHR), LDS_BYTES, stream, a); }
#endif
}
```
